# Optimizing an MI355X kernel written in HIP

```python
import math
import jax, jax.numpy as jnp
from jax import lax
import numpy as np

D_MODEL = 1024
BATCH = 8
SEQ = 2048
DEPTH = 4

N_MIXERS = 2
N_RET_LAYERS = (DEPTH + 1) // 2
N_MLA_LAYERS = DEPTH // 2
MIX_WIDTH = D_MODEL
MEM_LEN = 256
MEM_HEADS = 4
MEM_HEAD_DIM = 64
MEM_WIDTH = MEM_HEADS * MEM_HEAD_DIM
TOK_WIDTH = MIX_WIDTH - MEM_WIDTH
RET_HEADS = 6
RET_DK = 128
RET_DV = TOK_WIDTH // RET_HEADS
RET_CHUNK = 128
RET_IN = 4 * TOK_WIDTH + MEM_WIDTH
MLA_HEADS = 6
MLA_NOPE = 64
MLA_ROPE = 32
MLA_DV = TOK_WIDTH // MLA_HEADS
MLA_Q_RANK = 256
MLA_KV_RANK = 128
MLA_IN = MLA_Q_RANK + MLA_KV_RANK + MLA_ROPE + MEM_WIDTH
MLA_SCALE = (MLA_NOPE + MLA_ROPE) ** -0.5
Q_BLOCK = 128
D_FF = 2816
FFN_RES_WEIGHT = 0.5
ROPE_THETA = 10000.0
NORM_EPS = 1e-6

kernel_name = "hybrid_retention_mla_memory_macaron_encoder"


def rms_norm(x, g):
    xf = x.astype(jnp.float32)
    y = xf * lax.rsqrt(jnp.mean(xf * xf, axis=-1, keepdims=True) + NORM_EPS)
    return (y * g.astype(jnp.float32)).astype(x.dtype)


def head_layer_norm(y, g):
    mu = jnp.mean(y, axis=-1, keepdims=True)
    var = jnp.mean(jnp.square(y - mu), axis=-1, keepdims=True)
    return (y - mu) * lax.rsqrt(var + NORM_EPS) * g.astype(jnp.float32)


def rope_tables(positions, dim):
    inv = 1.0 / (ROPE_THETA ** (jnp.arange(0, dim, 2, dtype=jnp.float32) / dim))
    ang = positions.astype(jnp.float32)[..., None] * inv
    return jnp.cos(ang), jnp.sin(ang)


def apply_rope(x, cos, sin):
    half = x.shape[-1] // 2
    x1, x2 = x[..., :half], x[..., half:]
    c = cos[:, :, None, :].astype(x.dtype)
    s = sin[:, :, None, :].astype(x.dtype)
    return jnp.concatenate([x1 * c - x2 * s, x1 * s + x2 * c], axis=-1)


def swiglu(h, w_gu, w_down):
    g, u = jnp.split(h @ w_gu, 2, axis=-1)
    return (jax.nn.silu(g) * u) @ w_down


def retention_chunkwise(q, k, v, log_gamma, strict):
    B, S, H, dk = q.shape
    dv = v.shape[-1]
    n = S // RET_CHUNK
    C = RET_CHUNK
    q = q.astype(jnp.float32).reshape(B, n, C, H, dk)
    k = k.astype(jnp.float32).reshape(B, n, C, H, dk)
    v = v.astype(jnp.float32).reshape(B, n, C, H, dv)
    lg = log_gamma.astype(jnp.float32)
    idx = jnp.arange(C, dtype=jnp.float32)
    diff = idx[:, None] - idx[None, :]
    mask = diff > 0 if strict else diff >= 0
    decay = jnp.where(mask[None], jnp.exp(jnp.where(mask, diff, 0.0)[None] * lg[:, None, None]), 0.0)
    scores = jnp.einsum('bnihd,bnjhd->bnhij', q, k) * decay[None, None]
    intra = jnp.einsum('bnhij,bnjhv->bnihv', scores, v)
    k_w = k * jnp.exp((C - 1.0 - idx)[:, None] * lg[None, :])[None, None, :, :, None]
    chunk_kv = jnp.einsum('bnjhd,bnjhv->bnhdv', k_w, v)
    g_chunk = jnp.exp(C * lg)[None, :, None, None]

    def step(state, kv_n):
        return state * g_chunk + kv_n, state

    init = jnp.zeros((B, H, dk, dv), jnp.float32)
    _, states = lax.scan(step, init, jnp.moveaxis(chunk_kv, 1, 0))
    states = jnp.moveaxis(states, 0, 1)
    q_w = q * jnp.exp((idx + 1.0)[:, None] * lg[None, :])[None, None, :, :, None]
    cross = jnp.einsum('bnihd,bnhdv->bnihv', q_w, states)
    return (intra + cross).reshape(B, S, H, dv)


def retention_mixer(h, w_in, log_decay, head_norm, cos, sin):
    B, S, _ = h.shape
    T = TOK_WIDTH
    q, k, v, g, qm = jnp.split(h @ w_in, [T, 2 * T, 3 * T, 4 * T], axis=-1)
    q = apply_rope(q.reshape(B, S, RET_HEADS, RET_DK), cos, sin)
    k = apply_rope(k.reshape(B, S, RET_HEADS, RET_DK), cos, sin) * (RET_DK ** -0.5)
    v = v.reshape(B, S, RET_HEADS, RET_DV)
    y_fwd = retention_chunkwise(q, k, v, log_decay[0], strict=False)
    y_bwd = retention_chunkwise(q[:, ::-1], k[:, ::-1], v[:, ::-1], log_decay[1], strict=True)[:, ::-1]
    y = head_layer_norm(y_fwd + y_bwd, head_norm).reshape(B, S, T).astype(h.dtype)
    return jax.nn.silu(g) * y, qm


def dense_attention_blocked(q, k, v, scale):
    B, S, H, dq = q.shape
    dv = v.shape[-1]
    n = S // Q_BLOCK
    qb = q.reshape(B, n, Q_BLOCK, H, dq).transpose(1, 0, 2, 3, 4)

    def one_block(q_blk):
        s = jnp.einsum('bqhd,bkhd->bhqk', q_blk, k).astype(jnp.float32) * scale
        p = jax.nn.softmax(s, axis=-1).astype(v.dtype)
        return jnp.einsum('bhqk,bkhv->bqhv', p, v)

    o = lax.map(one_block, qb)
    return o.transpose(1, 0, 2, 3, 4).reshape(B, S, H * dv)


def mla_mixer(h, w_in, q_norm, kv_norm, w_uq, w_ukv, cos, sin):
    B, S, _ = h.shape
    c_q, c_kv, k_r, qm = jnp.split(
        h @ w_in, [MLA_Q_RANK, MLA_Q_RANK + MLA_KV_RANK, MLA_Q_RANK + MLA_KV_RANK + MLA_ROPE], axis=-1)
    c_q = rms_norm(c_q, q_norm)
    c_kv = rms_norm(c_kv, kv_norm)
    q = (c_q @ w_uq).reshape(B, S, MLA_HEADS, MLA_NOPE + MLA_ROPE)
    q = jnp.concatenate([q[..., :MLA_NOPE], apply_rope(q[..., MLA_NOPE:], cos, sin)], axis=-1)
    kv = (c_kv @ w_ukv).reshape(B, S, MLA_HEADS, MLA_NOPE + MLA_DV)
    k_nope, v = kv[..., :MLA_NOPE], kv[..., MLA_NOPE:]
    k_rope = apply_rope(k_r.reshape(B, S, 1, MLA_ROPE), cos, sin)
    k = jnp.concatenate([k_nope, jnp.broadcast_to(k_rope, (B, S, MLA_HEADS, MLA_ROPE))], axis=-1)
    return dense_attention_blocked(q, k, v, MLA_SCALE), qm


def memory_attention(qm, mem_n, w_kv):
    B, S, _ = qm.shape
    L = mem_n.shape[1]
    q = qm.reshape(B, S, MEM_HEADS, MEM_HEAD_DIM)
    mk, mv = jnp.split(mem_n @ w_kv, 2, axis=-1)
    mk = mk.reshape(B, L, MEM_HEADS, MEM_HEAD_DIM)
    mv = mv.reshape(B, L, MEM_HEADS, MEM_HEAD_DIM)
    s = jnp.einsum('bshd,bmhd->bhsm', q, mk).astype(jnp.float32) * (MEM_HEAD_DIM ** -0.5)
    p = jax.nn.softmax(s, axis=-1).astype(mv.dtype)
    return jnp.einsum('bhsm,bmhd->bshd', p, mv).reshape(B, S, MEM_WIDTH)


def setup_inputs(seed: int = 0) -> dict:
    key = jax.random.key(seed)
    ks = jax.random.split(key, 17)
    f32 = jnp.float32

    def w(k, shape, fan_in):
        return jax.random.normal(k, shape, f32) * (fan_in ** -0.5)

    def gain(k, shape):
        return 1.0 + 0.02 * jax.random.normal(k, shape, f32)

    x = jax.random.normal(ks[0], (BATCH, SEQ, D_MODEL), f32)
    mem = jax.random.normal(ks[1], (BATCH, MEM_LEN, D_MODEL), f32)
    offsets = jax.random.randint(ks[2], (BATCH, 1), 0, 1024, dtype=jnp.int32)
    positions = (offsets + jnp.arange(SEQ, dtype=jnp.int32)[None, :]).astype(jnp.int32)
    base_decay = jnp.log(1.0 - 2.0 ** (-5.0 - jnp.arange(RET_HEADS, dtype=f32)))
    ret_log_decay = base_decay[None, None, :] * (1.0 + 0.05 * jax.random.normal(ks[10], (N_RET_LAYERS, 2, RET_HEADS), f32))
    return {
        "x": x,
        "mem": mem,
        "positions": positions,
        "norm_gains": gain(ks[3], (DEPTH, 6, D_MODEL)),
        "ffn_w_gu": w(ks[4], (DEPTH, 2, D_MODEL, 2 * D_FF), D_MODEL),
        "ffn_w_down": w(ks[5], (DEPTH, 2, D_FF, D_MODEL), D_FF),
        "w_o": w(ks[6], (DEPTH, MIX_WIDTH, D_MODEL), MIX_WIDTH),
        "mem_norm": gain(ks[7], (D_MODEL,)),
        "mem_w_kv": w(ks[8], (DEPTH, D_MODEL, 2 * MEM_WIDTH), D_MODEL),
        "ret_w_in": w(ks[9], (N_RET_LAYERS, D_MODEL, RET_IN), D_MODEL),
        "ret_log_decay": ret_log_decay,
        "ret_head_norm": gain(ks[11], (N_RET_LAYERS, RET_HEADS, RET_DV)),
        "mla_w_in": w(ks[12], (N_MLA_LAYERS, D_MODEL, MLA_IN), D_MODEL),
        "mla_q_norm": gain(ks[13], (N_MLA_LAYERS, MLA_Q_RANK)),
        "mla_kv_norm": gain(ks[14], (N_MLA_LAYERS, MLA_KV_RANK)),
        "mla_w_uq": w(ks[15], (N_MLA_LAYERS, MLA_Q_RANK, MLA_HEADS * (MLA_NOPE + MLA_ROPE)), MLA_Q_RANK),
        "mla_w_ukv": w(ks[16], (N_MLA_LAYERS, MLA_KV_RANK, MLA_HEADS * (MLA_NOPE + MLA_DV)), MLA_KV_RANK),
    }


def reference(x, mem, positions, norm_gains, ffn_w_gu, ffn_w_down, w_o, mem_norm, mem_w_kv,
              ret_w_in, ret_log_decay, ret_head_norm,
              mla_w_in, mla_q_norm, mla_kv_norm, mla_w_uq, mla_w_ukv):
    cos_ret, sin_ret = rope_tables(positions, RET_DK)
    cos_mla, sin_mla = rope_tables(positions, MLA_ROPE)
    mem_n = rms_norm(mem, mem_norm)

    for l in range(DEPTH):
        ng = norm_gains[l]
        x = x + FFN_RES_WEIGHT * rms_norm(swiglu(rms_norm(x, ng[0]), ffn_w_gu[l, 0], ffn_w_down[l, 0]), ng[1])
        h = rms_norm(x, ng[2])
        r = l // N_MIXERS
        if l % N_MIXERS == 0:
            tok, qm = retention_mixer(h, ret_w_in[r], ret_log_decay[r], ret_head_norm[r], cos_ret, sin_ret)
        else:
            tok, qm = mla_mixer(h, mla_w_in[r], mla_q_norm[r], mla_kv_norm[r], mla_w_uq[r], mla_w_ukv[r],
                                cos_mla, sin_mla)
        mem_out = memory_attention(qm, mem_n, mem_w_kv[l])
        mix = jnp.concatenate([tok, mem_out], axis=-1) @ w_o[l]
        x = x + rms_norm(mix, ng[3])
        x = x + FFN_RES_WEIGHT * rms_norm(swiglu(rms_norm(x, ng[4]), ffn_w_gu[l, 1], ffn_w_down[l, 1]), ng[5])
    return x
```

```cpp
#include <hip/hip_runtime.h>
#include <hip/hip_cooperative_groups.h>
#include <cstdio>
#include <cstdint>
namespace cg = cooperative_groups;
typedef float f32x4_g __attribute__((ext_vector_type(4)));
constexpr int NWAVES = 8;
constexpr int BATCH = 8, SEQ = 2048, DM = 1024, DEPTH = 4, M = BATCH * SEQ, DFF = 2816, MEML = 256;
constexpr int RET_IN = 3328, MLA_IN = 672, MLA_INP = 768, UQ_N = 576, UQ_NP = 768, UKV_N = 1152, UKV_NP = 1280;
constexpr float EPS = 1e-6f;
constexpr int LDS_BYTES = 147456;
constexpr size_t MiB = 1u << 20;
constexpr size_t WS_WGU = 1 * MiB;
constexpr size_t WS_WDN = WS_WGU + 88 * MiB;
constexpr size_t WS_WO = WS_WDN + 44 * MiB;
constexpr size_t WS_WRIN = WS_WO + 8 * MiB;
constexpr size_t WS_WMIN = WS_WRIN + 13 * MiB;
constexpr size_t WS_WUQ = WS_WMIN + 3 * MiB;
constexpr size_t WS_WUKV = WS_WUQ + 1 * MiB;
constexpr size_t WS_WMKV = WS_WUKV + 1 * MiB;
constexpr size_t WS_MEMN = WS_WMKV + 4 * MiB;
constexpr size_t WS_MEMKV = WS_MEMN + 4 * MiB;
constexpr size_t WS_RCOS = WS_MEMKV + 8 * MiB;
constexpr size_t WS_RSIN = WS_RCOS + 4 * MiB;
constexpr size_t WS_MCOS = WS_RSIN + 4 * MiB;
constexpr size_t WS_MSIN = WS_MCOS + 1 * MiB;
constexpr size_t WS_SSQ = WS_MSIN + 1 * MiB;
constexpr size_t WS_SSKV = WS_SSQ + 1 * MiB;
constexpr size_t WS_XB = WS_SSKV + 1 * MiB;
constexpr size_t WS_DBUF = WS_XB + 32 * MiB;
constexpr size_t WS_MIX = WS_DBUF + 64 * MiB;
constexpr size_t WS_QM = WS_MIX + 32 * MiB;
constexpr size_t WS_BIG = WS_QM + 8 * MiB;
constexpr size_t WS_END = WS_BIG + 96 * MiB;
constexpr size_t BIG_Q = 0, BIG_K = 24 * MiB, BIG_V = 48 * MiB, BIG_G = 72 * MiB;
constexpr size_t BIG_CQ = 0, BIG_CKV = 8 * MiB, BIG_KR = 12 * MiB, BIG_QF = 13 * MiB, BIG_KN = 31 * MiB, BIG_VV = 43 * MiB;

namespace pg8 {
#define PG8_LAS __attribute__((address_space(3)))
typedef unsigned short bf16_t;
typedef short bf16x8 __attribute__((ext_vector_type(8)));
typedef float f32x4 __attribute__((ext_vector_type(4)));
typedef unsigned u32x4 __attribute__((ext_vector_type(4)));
constexpr int BM = 256, BK = 64, HALF = 128, HTB = HALF * BK * 2  , STAGE_BYTES = 8 * HTB, NXCD = 8, WGM = 8;

__host__ __device__ __forceinline__ int lds_byte(int r, int c) { const int st = (r >> 4) * 2 + (c >> 5), rr = r & 15, cc = c & 31, ob = rr * 64 + cc * 2; return st * 1024 + (ob ^ (((ob >> 9) & 1) << 5)); }
__host__ __device__ __forceinline__ void stage_rc(int b, int& R, int& C) { const int st = b / 1024, sb = b % 1024, swz = sb ^ (((sb >> 9) & 1) << 5); R = (st >> 1) * 16 + swz / 64; C = (st & 1) * 32 + (swz % 64) / 2; }
__host__ __device__ __forceinline__ int perm32(int rho) { const int n = rho >> 4, i = rho & 15; return 8 * (i >> 2) + 4 * n + (i & 3); }

struct Unit { int pm, pn; };
struct Gemm { const bf16_t* A; const bf16_t* Bt; int M, N, K; };

struct StaticOrder {
    int nM, nN, nwg, G, c;
    __host__ __device__ void init(int M, int N, int G_, int c_) { nM = M / BM; nN = N / BM; nwg = nM * nN; G = G_; c = c_; }
    __host__ __device__ bool next(int i, Unit& u) const {
        const long L = (long)i * G + c; if (L >= nwg) return false;
        int wgid = (int)L; { const int q = nwg / NXCD, r = nwg % NXCD, xcd = wgid % NXCD, off = wgid / NXCD; wgid = (xcd < r ? xcd * (q + 1) : r * (q + 1) + (xcd - r) * q) + off; }
        const int nig = WGM * nN, gid = wgid / nig, fm = gid * WGM, gsz = (nM - fm) < WGM ? (nM - fm) : WGM;
        u.pm = fm + ((wgid % nig) % gsz); u.pn = (wgid % nig) / gsz; return true;
    }
    __device__ __forceinline__ void a_ready(const Unit&) const {}
    __device__ __forceinline__ void done(const Unit&) const {}
};


__device__ __forceinline__ unsigned cvt_pk_bf16(float lo, float hi) { unsigned r; asm volatile("v_cvt_pk_bf16_f32 %0, %1, %2" : "=v"(r) : "v"(lo), "v"(hi)); return r; }
typedef unsigned u32x2 __attribute__((ext_vector_type(2)));
__device__ __forceinline__ void st8(bf16_t* p, f32x4 v0, f32x4 v1) { u32x4 w; w.x = cvt_pk_bf16(v0[0], v0[1]); w.y = cvt_pk_bf16(v0[2], v0[3]); w.z = cvt_pk_bf16(v1[0], v1[1]); w.w = cvt_pk_bf16(v1[2], v1[3]); *(u32x4*)p = w; }
__device__ __forceinline__ void st4(bf16_t* p, f32x4 v0) { u32x2 w; w.x = cvt_pk_bf16(v0[0], v0[1]); w.y = cvt_pk_bf16(v0[2], v0[3]); *(u32x2*)p = w; }
__device__ __forceinline__ float silu1(float g) { return g * __builtin_amdgcn_rcpf(1.0f + __builtin_amdgcn_exp2f(-1.4426950408889634f * g)); }
__device__ __forceinline__ f32x4 silu4(f32x4 g) { return (f32x4){silu1(g[0]), silu1(g[1]), silu1(g[2]), silu1(g[3])}; }

enum { EK_BF16 = 0, EK_F32 = 1, EK_SWIGLU = 2, EK_RETIN = 3, EK_MLAIN = 4, EK_UQ = 5, EK_UKV = 6 };
constexpr float EPS_N = 1e-6f;
struct Epi {
    static constexpr bool PERM = true, AFTER_DRAIN = false;
    int kind; unsigned char* ws;
    __device__ __forceinline__ void operator()(const f32x4 (&acc)[2][2][4][2], const Unit& u, int wr, int wc, int fr, int fq) const {
        const int row0 = u.pm * BM + wr * 64 + fr, pn = u.pn, t = wc * 32 + fq * 8;
        unsigned char* const big = ws + WS_BIG; bf16_t* const qm = (bf16_t*)(ws + WS_QM);
        if (kind == EK_BF16) {
#pragma unroll
            for (int ai = 0; ai < 2; ++ai)
#pragma unroll
                for (int m = 0; m < 4; ++m) { bf16_t* rp = (bf16_t*)(ws + WS_MEMKV) + (size_t)(row0 + ai * HALF + m * 16) * 2048 + pn * BM + t;
#pragma unroll
                    for (int bj = 0; bj < 2; ++bj) st8(rp + bj * HALF, acc[ai][bj][m][0], acc[ai][bj][m][1]); }
        } else if (kind == EK_F32) {
#pragma unroll
            for (int ai = 0; ai < 2; ++ai)
#pragma unroll
                for (int m = 0; m < 4; ++m) { float* rp = (float*)(ws + WS_DBUF) + (size_t)(row0 + ai * HALF + m * 16) * 1024 + pn * BM + t;
#pragma unroll
                    for (int bj = 0; bj < 2; ++bj) { *(f32x4*)(rp + bj * HALF) = acc[ai][bj][m][0]; *(f32x4*)(rp + bj * HALF + 4) = acc[ai][bj][m][1]; } }
        } else if (kind == EK_SWIGLU) {
#pragma unroll
            for (int ai = 0; ai < 2; ++ai)
#pragma unroll
                for (int m = 0; m < 4; ++m) { bf16_t* rp = (bf16_t*)big + (size_t)(row0 + ai * HALF + m * 16) * 2816 + pn * HALF + t;
                    st8(rp, silu4(acc[ai][0][m][0]) * acc[ai][1][m][0], silu4(acc[ai][0][m][1]) * acc[ai][1][m][1]); }
        } else if (kind == EK_RETIN) {
            if (pn < 6) {
                const int head = 2 * (pn % 3) + (wc >> 1), j0 = (wc & 1) * 32 + fq * 8;
                bf16_t* dst = (bf16_t*)(big + (pn < 3 ? BIG_Q : BIG_K)); const float* cs = (const float*)(ws + WS_RCOS); const float* sn = (const float*)(ws + WS_RSIN); const float sc = pn < 3 ? 1.0f : 0.08838834764831845f;
#pragma unroll
                for (int ai = 0; ai < 2; ++ai)
#pragma unroll
                    for (int m = 0; m < 4; ++m) { const int row = row0 + ai * HALF + m * 16;
                        const f32x4 c0 = *(const f32x4*)(cs + (size_t)row * 64 + j0) * sc, c1 = *(const f32x4*)(cs + (size_t)row * 64 + j0 + 4) * sc;
                        const f32x4 s0 = *(const f32x4*)(sn + (size_t)row * 64 + j0) * sc, s1 = *(const f32x4*)(sn + (size_t)row * 64 + j0 + 4) * sc;
                        const f32x4 a0 = acc[ai][0][m][0], a1 = acc[ai][0][m][1], b0 = acc[ai][1][m][0], b1 = acc[ai][1][m][1];
                        bf16_t* rp = dst + (size_t)row * 768 + head * 128 + j0;
                        st8(rp, a0 * c0 - b0 * s0, a1 * c1 - b1 * s1);
                        st8(rp + 64, a0 * s0 + b0 * c0, a1 * s1 + b1 * c1); }
            } else if (pn < 12) {
                bf16_t* dst = (bf16_t*)(big + (pn < 9 ? BIG_V : BIG_G)); const int cb = (pn < 9 ? pn - 6 : pn - 9) * BM + t; const bool act = pn >= 9;
#pragma unroll
                for (int ai = 0; ai < 2; ++ai)
#pragma unroll
                    for (int m = 0; m < 4; ++m) { bf16_t* rp = dst + (size_t)(row0 + ai * HALF + m * 16) * 768 + cb;
#pragma unroll
                        for (int bj = 0; bj < 2; ++bj) { f32x4 v0 = acc[ai][bj][m][0], v1 = acc[ai][bj][m][1]; if (act) { v0 = silu4(v0); v1 = silu4(v1); } st8(rp + bj * HALF, v0, v1); } }
            } else {
#pragma unroll
                for (int ai = 0; ai < 2; ++ai)
#pragma unroll
                    for (int m = 0; m < 4; ++m) { bf16_t* rp = qm + (size_t)(row0 + ai * HALF + m * 16) * 256 + t;
#pragma unroll
                        for (int bj = 0; bj < 2; ++bj) st8(rp + bj * HALF, acc[ai][bj][m][0], acc[ai][bj][m][1]); }
            }
        } else if (kind == EK_MLAIN) {
            if (pn == 0) {
#pragma unroll
                for (int ai = 0; ai < 2; ++ai)
#pragma unroll
                    for (int m = 0; m < 4; ++m) { const int row = row0 + ai * HALF + m * 16; bf16_t* rp = (bf16_t*)(big + BIG_CQ) + (size_t)row * 256 + t; float s = 0.f;
#pragma unroll
                        for (int bj = 0; bj < 2; ++bj) { const f32x4 v0 = acc[ai][bj][m][0], v1 = acc[ai][bj][m][1]; st8(rp + bj * HALF, v0, v1);
                            s += (v0[0] * v0[0] + v0[1] * v0[1]) + (v0[2] * v0[2] + v0[3] * v0[3]) + (v1[0] * v1[0] + v1[1] * v1[1]) + (v1[2] * v1[2] + v1[3] * v1[3]); }
                        s += __shfl_xor(s, 16); s += __shfl_xor(s, 32);
                        if (fq == 0) ((float*)(ws + WS_SSQ))[(size_t)row * 4 + wc] = s; }
            } else if (pn == 1) {
#pragma unroll
                for (int ai = 0; ai < 2; ++ai)
#pragma unroll
                    for (int m = 0; m < 4; ++m) { const int row = row0 + ai * HALF + m * 16;
                        const f32x4 v0 = acc[ai][0][m][0], v1 = acc[ai][0][m][1]; st8((bf16_t*)(big + BIG_CKV) + (size_t)row * 128 + t, v0, v1);
                        float s = (v0[0] * v0[0] + v0[1] * v0[1]) + (v0[2] * v0[2] + v0[3] * v0[3]) + (v1[0] * v1[0] + v1[1] * v1[1]) + (v1[2] * v1[2] + v1[3] * v1[3]);
                        s += __shfl_xor(s, 16); s += __shfl_xor(s, 32);
                        if (fq == 0) ((float*)(ws + WS_SSKV))[(size_t)row * 4 + wc] = s;
                        if (wc == 0) { const f32x4 c = *(const f32x4*)((const float*)(ws + WS_MCOS) + (size_t)row * 16 + 4 * fq), sv = *(const f32x4*)((const float*)(ws + WS_MSIN) + (size_t)row * 16 + 4 * fq); bf16_t* o2 = (bf16_t*)(big + BIG_KR);
                            const f32x4 x1 = acc[ai][1][m][0], x2 = acc[ai][1][m][1];
                            st4(o2 + (size_t)row * 32 + 4 * fq, x1 * c - x2 * sv); st4(o2 + (size_t)row * 32 + 16 + 4 * fq, x1 * sv + x2 * c); } }
            } else {
#pragma unroll
                for (int ai = 0; ai < 2; ++ai)
#pragma unroll
                    for (int m = 0; m < 4; ++m) { bf16_t* rp = qm + (size_t)(row0 + ai * HALF + m * 16) * 256 + t;
#pragma unroll
                        for (int bj = 0; bj < 2; ++bj) st8(rp + bj * HALF, acc[ai][bj][m][0], acc[ai][bj][m][1]); }
            }
        } else if (kind == EK_UQ) {
#pragma unroll
            for (int ai = 0; ai < 2; ++ai)
#pragma unroll
                for (int m = 0; m < 4; ++m) { const int row = row0 + ai * HALF + m * 16;
                    const f32x4 sp = *(const f32x4*)((const float*)(ws + WS_SSQ) + (size_t)row * 4); const float rs = 1.0f / sqrtf(((sp[0] + sp[1]) + (sp[2] + sp[3])) * (1.0f / 256.0f) + EPS_N);
                    bf16_t* qrow = (bf16_t*)(big + BIG_QF) + (size_t)row * 576;
#pragma unroll
                    for (int bj = 0; bj < 2; ++bj) {
                        const int grp = pn * 8 + bj * 4 + wc;
                        const f32x4 v0 = acc[ai][bj][m][0] * rs, v1 = acc[ai][bj][m][1] * rs;
                        if (grp < 12) { const int head = grp >> 1, d = (grp & 1) * 32 + fq * 8; st8(qrow + head * 96 + d, v0, v1); }
                        else if (grp < 18) { const int hh = grp - 12; const f32x4 c = *(const f32x4*)((const float*)(ws + WS_MCOS) + (size_t)row * 16 + 4 * fq), sv = *(const f32x4*)((const float*)(ws + WS_MSIN) + (size_t)row * 16 + 4 * fq);
                            st4(qrow + hh * 96 + 64 + 4 * fq, v0 * c - v1 * sv); st4(qrow + hh * 96 + 80 + 4 * fq, v0 * sv + v1 * c); }
                    } }
        } else {
#pragma unroll
            for (int ai = 0; ai < 2; ++ai)
#pragma unroll
                for (int m = 0; m < 4; ++m) { const int row = row0 + ai * HALF + m * 16;
                    const f32x4 sp = *(const f32x4*)((const float*)(ws + WS_SSKV) + (size_t)row * 4); const float rs = 1.0f / sqrtf(((sp[0] + sp[1]) + (sp[2] + sp[3])) * (1.0f / 128.0f) + EPS_N);
#pragma unroll
                    for (int bj = 0; bj < 2; ++bj) { const int cidx = pn * BM + bj * HALF + t;
                        const f32x4 v0 = acc[ai][bj][m][0] * rs, v1 = acc[ai][bj][m][1] * rs;
                        if (cidx < 384) st8((bf16_t*)(big + BIG_KN) + (size_t)row * 384 + cidx, v0, v1);
                        else if (cidx >= 512) st8((bf16_t*)(big + BIG_VV) + (size_t)row * 768 + (cidx - 512), v0, v1); } }
        }
    }
};

template <class Epi, class Sched, bool ALIGN_EPI = false, bool SP2 = false>
__device__ __forceinline__ void gemm_phase(PG8_LAS unsigned char* lds, const Gemm g, const Sched& S, const Epi& E) {
    int tid_ = threadIdx.x; asm volatile("" : "+v"(tid_));
    const int tid = tid_, wid = __builtin_amdgcn_readfirstlane(tid >> 6), lane = tid & 63, wr = wid >> 2, wc = wid & 3, fr = lane & 15, fq = lane >> 4;
    const int K = g.K, nt = K / BK;
    unsigned voffA[2], voffB[2];
#pragma unroll
    for (int i = 0; i < 2; ++i) { int R, C; stage_rc(tid * 16 + i * 8192, R, C); const int Rb = Epi::PERM ? ((R & ~31) + perm32(R & 31)) : R;
        voffA[i] = (unsigned)(R * K + C) * 2u; voffB[i] = (unsigned)(Rb * K + C) * 2u; }
    const size_t kstep = (size_t)(BK * 2);
    const size_t hstep = (size_t)HALF * K * 2;
    const size_t tstep = 2 * hstep;
    const unsigned ldsw = (unsigned)wid * 1024u;
    const int aoff = lds_byte(wr * 64 + fr, fq * 8), boff = lds_byte(wc * 32 + fr, fq * 8);
#define PG8_SA(b, h) (((b) * 2 + (h)) * HTB)
#define PG8_SB(b, h) ((4 + (b) * 2 + (h)) * HTB)
#define PG8_STAGE(bufoff, gbase, voff) do { _Pragma("unroll") for (int _i = 0; _i < 2; ++_i) \
        __builtin_amdgcn_global_load_lds((const unsigned*)((const char*)(gbase) + (voff)[_i]), (PG8_LAS unsigned*)(lds + (bufoff) + ldsw + _i * 8192), 16, 0, 0); } while (0)
#define PG8_LDA(dst, b, h) do { _Pragma("unroll") for (int m = 0; m < 4; ++m) _Pragma("unroll") for (int k = 0; k < 2; ++k) dst[m][k] = *(const PG8_LAS bf16x8*)(lds + PG8_SA(b, h) + aoff + m * 2048 + k * 1024); } while (0)
#define PG8_LDB(dst, b, h) do { _Pragma("unroll") for (int n = 0; n < 2; ++n) _Pragma("unroll") for (int k = 0; k < 2; ++k) dst[n][k] = *(const PG8_LAS bf16x8*)(lds + PG8_SB(b, h) + boff + n * 2048 + k * 1024); } while (0)
#define PG8_MMA(ai, bj, At, Bt) do { __builtin_amdgcn_s_setprio(1); _Pragma("unroll") for (int m = 0; m < 4; ++m) _Pragma("unroll") for (int n = 0; n < 2; ++n) _Pragma("unroll") for (int k = 0; k < 2; ++k) \
        acc[ai][bj][m][n] = __builtin_amdgcn_mfma_f32_16x16x32_bf16(Bt[n][k], At[m][k], acc[ai][bj][m][n], 0, 0, 0); __builtin_amdgcn_s_setprio(0); } while (0)
#define PG8_WAIT_V(n) asm volatile("s_waitcnt vmcnt(" #n ")" ::: "memory")
#define PG8_WAIT_L(n) asm volatile("s_waitcnt lgkmcnt(" #n ")" ::: "memory")
#define PG8_BAR __builtin_amdgcn_s_barrier()
#define PG8_SCHED __builtin_amdgcn_sched_barrier(0)
    Unit cur, nxt; int ui = 0;
    if (!S.next(0, cur)) return;
    f32x4 acc[2][2][4][2];
#pragma unroll
    for (int a = 0; a < 2; ++a)
#pragma unroll
        for (int b = 0; b < 2; ++b)
#pragma unroll
            for (int m = 0; m < 4; ++m)
#pragma unroll
                for (int n = 0; n < 2; ++n) acc[a][b][m][n] = (f32x4){0.f, 0.f, 0.f, 0.f};
    bf16x8 At[4][2], B0[2][2], B1[2][2];
    const char* cA = (const char*)g.A + (size_t)cur.pm * tstep; const char* cB = (const char*)g.Bt + (size_t)cur.pn * tstep;
    S.a_ready(cur);
    if constexpr (SP2) {
        PG8_STAGE(PG8_SB(0, 0), cB, voffB); PG8_STAGE(PG8_SB(0, 1), cB + hstep, voffB); PG8_STAGE(PG8_SA(0, 0), cA, voffA); PG8_STAGE(PG8_SA(0, 1), cA + hstep, voffA);
        if (wr == 1) PG8_BAR;
        PG8_WAIT_V(2); PG8_BAR;
        PG8_STAGE(PG8_SB(1, 0), cB + kstep, voffB); PG8_STAGE(PG8_SA(1, 0), cA + kstep, voffA); PG8_STAGE(PG8_SB(1, 1), cB + hstep + kstep, voffB);
        PG8_WAIT_V(6); PG8_BAR;
    } else {
        PG8_STAGE(PG8_SB(0, 0), cB, voffB); PG8_STAGE(PG8_SA(0, 0), cA, voffA); PG8_STAGE(PG8_SB(0, 1), cB + hstep, voffB); PG8_STAGE(PG8_SA(0, 1), cA + hstep, voffA);
        if (wr == 1) PG8_BAR;
        PG8_WAIT_V(4); PG8_BAR;
        PG8_STAGE(PG8_SB(1, 0), cB + kstep, voffB); PG8_STAGE(PG8_SA(1, 0), cA + kstep, voffA); PG8_STAGE(PG8_SB(1, 1), cB + hstep + kstep, voffB);
        PG8_WAIT_V(6); PG8_BAR;
    }
    for (;;) {
        const bool has_next = S.next(ui + 1, nxt);
        const char* nA = has_next ? (const char*)g.A + (size_t)nxt.pm * tstep : cA; const char* nB = has_next ? (const char*)g.Bt + (size_t)nxt.pn * tstep : cB;
        for (int t = 0; t < nt; t += 2) {
            const bool last = (t == nt - 2);
            const char* a1 = cA + (size_t)(t + 1) * kstep;
            const char* a2 = last ? nA : cA + (size_t)(t + 2) * kstep; const char* b2 = last ? nB : cB + (size_t)(t + 2) * kstep;
            const char* a3 = a2 + kstep; const char* b3 = b2 + kstep;
            if (last && has_next) S.a_ready(nxt);
            if constexpr (SP2) {
            PG8_LDB(B0, 0, 0); PG8_LDB(B1, 0, 1); PG8_SCHED; PG8_LDA(At, 0, 0); PG8_STAGE(PG8_SA(1, 1), a1 + hstep, voffA);
            PG8_WAIT_V(8); PG8_WAIT_L(0); PG8_BAR; PG8_MMA(0, 0, At, B0); PG8_MMA(0, 1, At, B1); PG8_BAR; PG8_SCHED;
            PG8_LDA(At, 0, 1); PG8_STAGE(PG8_SB(0, 0), b2, voffB); PG8_STAGE(PG8_SB(0, 1), b2 + hstep, voffB); PG8_STAGE(PG8_SA(0, 0), a2, voffA);
            PG8_WAIT_V(8); PG8_WAIT_L(0); PG8_BAR; PG8_MMA(1, 0, At, B0); PG8_MMA(1, 1, At, B1); PG8_BAR; PG8_SCHED;
            PG8_LDB(B0, 1, 0); PG8_LDB(B1, 1, 1); PG8_SCHED; PG8_LDA(At, 1, 0); PG8_STAGE(PG8_SA(0, 1), a2 + hstep, voffA);
            PG8_WAIT_V(8); PG8_WAIT_L(0); PG8_BAR; PG8_MMA(0, 0, At, B0); PG8_MMA(0, 1, At, B1); PG8_BAR; PG8_SCHED;
            PG8_LDA(At, 1, 1); PG8_STAGE(PG8_SB(1, 0), b3, voffB); PG8_STAGE(PG8_SB(1, 1), b3 + hstep, voffB); PG8_STAGE(PG8_SA(1, 0), a3, voffA);
            PG8_WAIT_V(8); PG8_WAIT_L(0); PG8_BAR; PG8_MMA(1, 0, At, B0); PG8_MMA(1, 1, At, B1); PG8_BAR; PG8_SCHED;
            } else {
            PG8_LDB(B0, 0, 0); PG8_SCHED; PG8_LDA(At, 0, 0); PG8_STAGE(PG8_SA(1, 1), a1 + hstep, voffA);
            PG8_WAIT_L(8); PG8_BAR; PG8_WAIT_L(0); PG8_MMA(0, 0, At, B0); PG8_BAR; PG8_SCHED;
            PG8_LDB(B1, 0, 1); PG8_STAGE(PG8_SB(0, 0), b2, voffB);
            PG8_BAR; PG8_WAIT_L(0); PG8_MMA(0, 1, At, B1); PG8_BAR;
            PG8_LDA(At, 0, 1); PG8_STAGE(PG8_SA(0, 0), a2, voffA);
            PG8_BAR; PG8_WAIT_L(0); PG8_MMA(1, 0, At, B0); PG8_BAR; PG8_SCHED;
            PG8_STAGE(PG8_SB(0, 1), b2 + hstep, voffB);
            PG8_WAIT_V(6); PG8_BAR; PG8_MMA(1, 1, At, B1); PG8_BAR;
            PG8_LDB(B0, 1, 0); PG8_SCHED; PG8_LDA(At, 1, 0); PG8_STAGE(PG8_SA(0, 1), a2 + hstep, voffA);
            PG8_WAIT_L(8); PG8_BAR; PG8_WAIT_L(0); PG8_MMA(0, 0, At, B0); PG8_BAR; PG8_SCHED;
            PG8_LDB(B1, 1, 1); PG8_STAGE(PG8_SB(1, 0), b3, voffB);
            PG8_BAR; PG8_WAIT_L(0); PG8_MMA(0, 1, At, B1); PG8_BAR;
            PG8_LDA(At, 1, 1); PG8_STAGE(PG8_SA(1, 0), a3, voffA);
            PG8_BAR; PG8_WAIT_L(0); PG8_MMA(1, 0, At, B0); PG8_BAR; PG8_SCHED;
            PG8_STAGE(PG8_SB(1, 1), b3 + hstep, voffB);
            PG8_WAIT_V(6); PG8_BAR; PG8_MMA(1, 1, At, B1); PG8_BAR;
            }
        }
        if constexpr (ALIGN_EPI) { if (wr == 0) PG8_BAR; }
        if constexpr (!Epi::AFTER_DRAIN) { E(acc, cur, wr, wc, fr, fq); S.done(cur); }
        if (!has_next) break;
#pragma unroll
        for (int a = 0; a < 2; ++a)
#pragma unroll
            for (int b = 0; b < 2; ++b)
#pragma unroll
                for (int m = 0; m < 4; ++m)
#pragma unroll
                    for (int n = 0; n < 2; ++n) acc[a][b][m][n] = (f32x4){0.f, 0.f, 0.f, 0.f};
        cur = nxt; cA = nA; cB = nB; ++ui;
        if constexpr (ALIGN_EPI) { if (wr == 1) PG8_BAR; }
    }
    PG8_WAIT_V(0);
    if constexpr (!ALIGN_EPI) { if (wr == 0) PG8_BAR; }
    PG8_BAR;
    if constexpr (Epi::AFTER_DRAIN) { E.fused(acc, cur, wr, wc, fr, fq, lds, wid, lane); S.done(cur); }
#undef PG8_SA
#undef PG8_SB
#undef PG8_STAGE
#undef PG8_LDA
#undef PG8_LDB
#undef PG8_MMA
#undef PG8_WAIT_V
#undef PG8_WAIT_L
#undef PG8_BAR
#undef PG8_SCHED
}
}

namespace att {
typedef unsigned short bf16;
using bf16x8 = __attribute__((ext_vector_type(8))) short;
using s16x4  = __attribute__((ext_vector_type(4))) short;
using f32x16 = __attribute__((ext_vector_type(16))) float;
using u32x4  = __attribute__((ext_vector_type(4))) unsigned;
constexpr int NW = 8, QBLK = 32, KVBLK = 64;
constexpr size_t SHM_V = KVBLK * 128 * 2, SHM_K = KVBLK * 128 * 2, SHM_ATTN = 2 * SHM_V + 2 * SHM_K + NW * 64 * 4;
#define KSWZ(row, colB) ((row) * 256 + ((colB) ^ (((row) & 7) << 4)))
#define SBAR() __builtin_amdgcn_sched_barrier(0)
__device__ __forceinline__ int crow(int r, int hi) { return (r & 3) + 8 * (r >> 2) + 4 * hi; }
__device__ __forceinline__ unsigned cvtpk(float lo, float hi) { unsigned r; asm volatile("v_cvt_pk_bf16_f32 %0, %1, %2" : "=v"(r) : "v"(lo), "v"(hi)); return r; }

struct Args {
  const bf16* Q; const bf16* K1; const bf16* K2; const bf16* V; bf16* O; const bf16* G; const float* hn;
  int seq, qpos0;
  float C, thr, lf, lb;
};

__device__ __forceinline__ void partialSM(f32x16& p0, f32x16& p1, float& m_reg, float& mn, float& alpha, float C, float thr) {
  float pmax = p0[0];
#pragma unroll
  for (int r = 1; r < 16; ++r) pmax = fmaxf(pmax, p0[r]);
#pragma unroll
  for (int r = 0; r < 16; ++r) pmax = fmaxf(pmax, p1[r]);
  { auto rr = __builtin_amdgcn_permlane32_swap(__float_as_uint(pmax), __float_as_uint(pmax), false, false);
    pmax = fmaxf(__uint_as_float(rr[0]), __uint_as_float(rr[1])); }
  if (__builtin_expect(__all(pmax - m_reg <= thr), 1)) { mn = m_reg; alpha = 1.f; }
  else { mn = fmaxf(m_reg, pmax); alpha = __builtin_amdgcn_exp2f((m_reg - mn) * C); m_reg = mn; }
  float mnC = -mn * C;
#pragma unroll
  for (int r = 0; r < 16; ++r) p0[r] = fmaf(p0[r], C, mnC);
#pragma unroll
  for (int r = 0; r < 16; ++r) p1[r] = fmaf(p1[r], C, mnC);
#pragma unroll
  for (int r = 0; r < 16; ++r) p0[r] = __builtin_amdgcn_exp2f(p0[r]);
}
#define PK4(P, BASE, OUT) do { unsigned a0 = cvtpk(P[BASE + 0], P[BASE + 1]), a1 = cvtpk(P[BASE + 2], P[BASE + 3]);   \
    unsigned b0 = cvtpk(P[BASE + 4], P[BASE + 5]), b1 = cvtpk(P[BASE + 6], P[BASE + 7]);                              \
    auto r0 = __builtin_amdgcn_permlane32_swap(a0, b0, false, false); auto r1 = __builtin_amdgcn_permlane32_swap(a1, b1, false, false); \
    u32x4 w = {r0[0], r1[0], r0[1], r1[1]}; OUT = *reinterpret_cast<bf16x8*>(&w); } while (0)
__device__ __forceinline__ void finishSM(f32x16& p0, f32x16& p1, float alpha, float& l_reg, bf16x8& pa0, bf16x8& pa1, bf16x8& pa2, bf16x8& pa3) {
#pragma unroll
  for (int r = 0; r < 16; ++r) p1[r] = __builtin_amdgcn_exp2f(p1[r]);
  float ps = 0;
#pragma unroll
  for (int r = 0; r < 16; ++r) ps += p0[r];
#pragma unroll
  for (int r = 0; r < 16; ++r) ps += p1[r];
  { auto rr = __builtin_amdgcn_permlane32_swap(__float_as_uint(ps), __float_as_uint(ps), false, false);
    ps = __uint_as_float(rr[0]) + __uint_as_float(rr[1]); }
  l_reg = l_reg * alpha + ps;
  PK4(p0, 0, pa0); PK4(p0, 8, pa1); PK4(p1, 0, pa2); PK4(p1, 8, pa3);
}
__device__ __forceinline__ void decayP(f32x16& p0, f32x16& p1, float fi, float lf, float lb) {
  const float Af = fi * lf, Ab = -fi * lb;
#pragma unroll
  for (int r = 0; r < 16; ++r) { const float c = (float)((r & 3) + 8 * (r >> 2)), c1 = c + 32.f;
    p0[r] *= __builtin_amdgcn_exp2f(fminf(fmaf(-c, lf, Af), fmaf(c, lb, Ab)));
    p1[r] *= __builtin_amdgcn_exp2f(fminf(fmaf(-c1, lf, Af), fmaf(c1, lb, Ab))); }
}
__device__ __forceinline__ void packP(f32x16& p0, f32x16& p1, bf16x8& pa0, bf16x8& pa1, bf16x8& pa2, bf16x8& pa3) {
  PK4(p0, 0, pa0); PK4(p0, 8, pa1); PK4(p1, 0, pa2); PK4(p1, 8, pa3);
}
template <int NDQ> __device__ __forceinline__ void qkt(f32x16& p0, f32x16& p1, const bf16* Ks, const bf16x8* qr, int r32, int hi) {
  p0 = f32x16{}; p1 = f32x16{};
#pragma unroll
  for (int d0 = 0; d0 < NDQ; ++d0) { int cb = (d0 * 16 + hi * 8) * 2;
    bf16x8 b0 = *reinterpret_cast<const bf16x8*>((const char*)Ks + KSWZ(r32, cb));
    bf16x8 b1 = *reinterpret_cast<const bf16x8*>((const char*)Ks + KSWZ(32 + r32, cb));
    p0 = __builtin_amdgcn_mfma_f32_32x32x16_bf16(b0, qr[d0], p0, 0, 0, 0);
    p1 = __builtin_amdgcn_mfma_f32_32x32x16_bf16(b1, qr[d0], p1, 0, 0, 0); }
}
__device__ __forceinline__ int v_st(int k, int c) { const int kk = (k & ~0xC) | ((k & 4) << 1) | ((k & 8) >> 1); return ((kk >> 3) * 4 + (c >> 5)) * 512 + ((kk & 7) * 32 + (c & 31)) * 2; }
__device__ __forceinline__ int v_rd_base(int lane) { return ((lane & 3) << 3) | (((lane >> 2) & 3) << 6) | (((lane >> 4) & 1) << 5) | (((lane >> 5) & 1) << 8); }
constexpr int v_rd_off(int d0, int ks, int half) { return d0 * 512 + ks * 4096 + half * 2048; }
template <int OFF> __device__ __forceinline__ s16x4 tr_read(int vb) {
  s16x4 r; asm volatile("ds_read_b64_tr_b16 %0, %1 offset:%2" : "=&v"(r) : "v"(vb), "i"(OFF) : "memory"); return r;
}
template <int D0> __device__ __forceinline__ void pv_one(f32x16& od, int vb, bf16x8 pa0, bf16x8 pa1, bf16x8 pa2, bf16x8 pa3) {
  const s16x4 l0 = tr_read<v_rd_off(D0, 0, 0)>(vb), h0 = tr_read<v_rd_off(D0, 0, 1)>(vb), l1 = tr_read<v_rd_off(D0, 1, 0)>(vb), h1 = tr_read<v_rd_off(D0, 1, 1)>(vb);
  const s16x4 l2 = tr_read<v_rd_off(D0, 2, 0)>(vb), h2 = tr_read<v_rd_off(D0, 2, 1)>(vb), l3 = tr_read<v_rd_off(D0, 3, 0)>(vb), h3 = tr_read<v_rd_off(D0, 3, 1)>(vb);
  asm volatile("s_waitcnt lgkmcnt(0)" ::: "memory"); SBAR();
#define PK(L, H) (bf16x8){L[0], L[1], L[2], L[3], H[0], H[1], H[2], H[3]}
  od = __builtin_amdgcn_mfma_f32_32x32x16_bf16(pa0, PK(l0, h0), od, 0, 0, 0);
  od = __builtin_amdgcn_mfma_f32_32x32x16_bf16(pa1, PK(l1, h1), od, 0, 0, 0);
  od = __builtin_amdgcn_mfma_f32_32x32x16_bf16(pa2, PK(l2, h2), od, 0, 0, 0);
  od = __builtin_amdgcn_mfma_f32_32x32x16_bf16(pa3, PK(l3, h3), od, 0, 0, 0);
#undef PK
}
template <int NDV> __device__ __forceinline__ void pv_d0(f32x16* o, int vb, bf16x8 pa0, bf16x8 pa1, bf16x8 pa2, bf16x8 pa3) {
  pv_one<0>(o[0], vb, pa0, pa1, pa2, pa3); pv_one<1>(o[1], vb, pa0, pa1, pa2, pa3);
  if constexpr (NDV == 4) { pv_one<2>(o[2], vb, pa0, pa1, pa2, pa3); pv_one<3>(o[3], vb, pa0, pa1, pa2, pa3); }
}

template <int MODE, int NDQ, int NDV, int DK1, int LDQ, int LDK1, int LDK2, int LDV>
__device__ __forceinline__ void unit(const Args& a, char* lds) {
  constexpr int LDO = 1024, LDG = 768;
  int tid_ = threadIdx.x; asm volatile("" : "+v"(tid_));
  const int tid = tid_, wid = tid >> 6, lane = tid & 63, r32 = lane & 31, hi = lane >> 5;
  bf16* V_lds = (bf16*)lds; bf16* K_lds = (bf16*)(lds + 2 * SHM_V);
  float* ws = (float*)(lds + 2 * SHM_V + 2 * SHM_K) + wid * 64; float* li_l = ws; float* al_l = ws + 32;
  float m_reg = -1e30f, l_reg = 0; f32x16 o[NDV]; bf16x8 qr[NDQ];
#pragma unroll
  for (int d = 0; d < NDV; ++d) o[d] = f32x16{};
  const bf16* __restrict__ Qw = a.Q + (long)(wid * QBLK + r32) * LDQ + hi * 8;
#pragma unroll
  for (int d0 = 0; d0 < NDQ; ++d0) qr[d0] = *reinterpret_cast<const bf16x8*>(Qw + d0 * 16);
  const int sr = tid >> 4, sc = (tid & 15) * 8, vst0 = v_st(sr, sc), vst1 = v_st(32 + sr, sc);
  const bool kact = sc < NDQ * 16, vact = sc < NDV * 32;
  const bool k1act = sc < DK1 && kact, k2act = sc >= DK1 && kact;
  const unsigned koff1 = (unsigned)(sr * LDK1 + sc), koff2 = (unsigned)(sr * LDK2 + (sc - DK1)), voff = (unsigned)(sr * LDV + sc);
  const bf16* __restrict__ K1p = a.K1; const bf16* __restrict__ K2p = a.K2; const bf16* __restrict__ Vp = a.V;
  const int vb0 = (int)(uintptr_t)V_lds + v_rd_base(lane);
  const float fq0 = (float)(a.qpos0 + wid * QBLK + r32 - 4 * hi);
  struct { bf16x8 vs0, vs1, ks0, ks1; } sr_[2];
#define SLOAD(i, k0) do { if (vact) { sr_[i].vs0 = *reinterpret_cast<const bf16x8*>(Vp + (size_t)(k0) * LDV + voff); sr_[i].vs1 = *reinterpret_cast<const bf16x8*>(Vp + (size_t)((k0) + 32) * LDV + voff); } \
    if (k1act) { sr_[i].ks0 = *reinterpret_cast<const bf16x8*>(K1p + (size_t)(k0) * LDK1 + koff1); sr_[i].ks1 = *reinterpret_cast<const bf16x8*>(K1p + (size_t)((k0) + 32) * LDK1 + koff1); } \
    if (DK1 < NDQ * 16) { if (k2act) { sr_[i].ks0 = *reinterpret_cast<const bf16x8*>(K2p + (size_t)(k0) * LDK2 + koff2); sr_[i].ks1 = *reinterpret_cast<const bf16x8*>(K2p + (size_t)((k0) + 32) * LDK2 + koff2); } } } while (0)
#define SWRITE(b, i) do { if (vact) { *(bf16x8*)((char*)V_lds + (b) * SHM_V + vst0) = sr_[i].vs0; *(bf16x8*)((char*)V_lds + (b) * SHM_V + vst1) = sr_[i].vs1; } \
    if (kact) { int kc = sc * 2; *(bf16x8*)((char*)K_lds + (b) * SHM_K + KSWZ(sr, kc)) = sr_[i].ks0; *(bf16x8*)((char*)K_lds + (b) * SHM_K + KSWZ(32 + sr, kc)) = sr_[i].ks1; } } while (0)
#define SWAIT() asm volatile("s_waitcnt vmcnt(4)" ::: "memory")
#define RESC(al) do { if (MODE == 0) { if (__any((al) < 1.f)) { if (hi == 0) al_l[r32] = (al); asm volatile("s_waitcnt lgkmcnt(0)" ::: "memory"); \
    _Pragma("unroll") for (int d = 0; d < NDV; ++d) _Pragma("unroll") for (int r = 0; r < 16; ++r) o[d][r] *= al_l[crow(r, hi)]; } } } while (0)
#define PART(P0, P1, mn_, al_, kb) do { if (MODE == 0) partialSM(P0, P1, m_reg, mn_, al_, a.C, a.thr); else decayP(P0, P1, fq0 - (float)(kb), a.lf, a.lb); } while (0)
#define FIN(P0, P1, al_) do { if (MODE == 0) finishSM(P0, P1, al_, l_reg, pa0, pa1, pa2, pa3); else packP(P0, P1, pa0, pa1, pa2, pa3); } while (0)
  f32x16 pA0, pA1, pB0, pB1; float mnA = 0.f, mnB = 0.f, alA = 1.f, alB = 1.f; bf16x8 pa0, pa1, pa2, pa3; const int NT = a.seq / KVBLK;
  constexpr int SE = 0, SO = 1;
  SLOAD(SE, 0); asm volatile("s_waitcnt vmcnt(0)" ::: "memory"); SWRITE(0, SE); __syncthreads();
  qkt<NDQ>(pA0, pA1, K_lds, qr, r32, hi); PART(pA0, pA1, mnA, alA, 0);
  SLOAD(SO, KVBLK); if (2 < NT) SLOAD(SE, 2 * KVBLK);
  SWAIT(); SWRITE(1, SO); __syncthreads();
  for (int j = 1; j + 1 < NT; j += 2) {
    SBAR(); qkt<NDQ>(pB0, pB1, (bf16*)((char*)K_lds + SHM_K), qr, r32, hi);
    FIN(pA0, pA1, alA); SBAR();
    SLOAD(SO, (j + 2) * KVBLK); SBAR();
    pv_d0<NDV>(o, vb0, pa0, pa1, pa2, pa3); PART(pB0, pB1, mnB, alB, j * KVBLK);
    __syncthreads(); SWAIT(); SWRITE(0, SE);
    RESC(alB); __syncthreads();
    SBAR(); qkt<NDQ>(pA0, pA1, K_lds, qr, r32, hi);
    FIN(pB0, pB1, alB); SBAR();
    if (j + 3 < NT) SLOAD(SE, (j + 3) * KVBLK); SBAR();
    pv_d0<NDV>(o, vb0 + (int)SHM_V, pa0, pa1, pa2, pa3); PART(pA0, pA1, mnA, alA, (j + 1) * KVBLK);
    __syncthreads(); SWAIT(); SWRITE(1, SO);
    RESC(alA); __syncthreads();
  }
  SBAR(); qkt<NDQ>(pB0, pB1, (bf16*)((char*)K_lds + SHM_K), qr, r32, hi);
  FIN(pA0, pA1, alA); SBAR();
  pv_d0<NDV>(o, vb0, pa0, pa1, pa2, pa3); PART(pB0, pB1, mnB, alB, (NT - 1) * KVBLK);
  __syncthreads(); RESC(alB);
  FIN(pB0, pB1, alB); SBAR();
  pv_d0<NDV>(o, vb0 + (int)SHM_V, pa0, pa1, pa2, pa3);
  bf16* Ow = a.O + (long)(wid * QBLK) * LDO;
  if constexpr (MODE == 0) {
    if (hi == 0) li_l[r32] = l_reg; asm volatile("s_waitcnt lgkmcnt(0)" ::: "memory");
#pragma unroll
    for (int r = 0; r < 16; ++r) { const int orow = crow(r, hi); const float rl = __builtin_amdgcn_rcpf(li_l[orow]);
#pragma unroll
      for (int d0 = 0; d0 < NDV; ++d0) Ow[(long)orow * LDO + d0 * 32 + r32] = (bf16)(cvtpk(o[d0][r] * rl, 0.f) & 0xffffu); }
  } else {
    const bf16* Gw = a.G + (long)(wid * QBLK) * LDG; float hnv[NDV];
#pragma unroll
    for (int d0 = 0; d0 < NDV; ++d0) hnv[d0] = a.hn[d0 * 32 + r32];
#pragma unroll
    for (int r = 0; r < 16; ++r) { const int orow = crow(r, hi);
      float s = 0.f;
#pragma unroll
      for (int d0 = 0; d0 < NDV; ++d0) s += o[d0][r];
#pragma unroll
      for (int x = 1; x < 32; x <<= 1) s += __shfl_xor(s, x);
      const float mu = s * (1.0f / (NDV * 32)); float q = 0.f;
#pragma unroll
      for (int d0 = 0; d0 < NDV; ++d0) { const float dd = o[d0][r] - mu; q += dd * dd; }
#pragma unroll
      for (int x = 1; x < 32; x <<= 1) q += __shfl_xor(q, x);
      const float rstd = 1.0f / sqrtf(q * (1.0f / (NDV * 32)) + 1e-6f);
#pragma unroll
      for (int d0 = 0; d0 < NDV; ++d0) { const unsigned gb = Gw[(long)orow * LDG + d0 * 32 + r32]; const float g = __uint_as_float(gb << 16);
        Ow[(long)orow * LDO + d0 * 32 + r32] = (bf16)(cvtpk((o[d0][r] - mu) * rstd * hnv[d0] * g, 0.f) & 0xffffu); } }
  }
#undef SLOAD
#undef SWRITE
#undef SWAIT
#undef RESC
#undef PART
#undef FIN
}
#undef SBAR
}

#define LAS __attribute__((address_space(3)))
typedef unsigned short bf16;
typedef unsigned v4u __attribute__((ext_vector_type(4)));
typedef unsigned v2u __attribute__((ext_vector_type(2)));
typedef float f32x4 __attribute__((ext_vector_type(4)));
__device__ __forceinline__ unsigned f2bf(float f) { unsigned u = __builtin_bit_cast(unsigned, f); return (u + 0x7fffu + ((u >> 16) & 1u)) >> 16; }
__device__ __forceinline__ unsigned pk2(float lo, float hi) { return f2bf(lo) | (f2bf(hi) << 16); }
__device__ __forceinline__ float wave_sum(float v) {
#pragma unroll
    for (int o = 1; o < 64; o <<= 1) v += __shfl_xor(v, o);
    return v;
}
enum { MAP_ID = 0, MAP_GU, MAP_RETIN, MAP_MLAIN, MAP_UQ, MAP_UKV };
__device__ __forceinline__ int map_row(int kind, int n) {
    switch (kind) {
    case MAP_GU: { const int half = n >= DFF ? 1 : 0, nn = n - half * DFF; return (nn >> 7) * 256 + half * 128 + (nn & 127); }
    case MAP_RETIN: { if (n >= 1536) return n; const int sec = n / 768, nn = n % 768, head = nn >> 7, d = nn & 127, half = d >> 6, j = d & 63;
        return (sec * 3 + (head >> 1)) * 256 + half * 128 + (head & 1) * 64 + j; }
    case MAP_MLAIN: { if (n < 384) return n; if (n < 416) { const int d = n - 384, half = d >> 4, jj = d & 15; return 384 + (jj >> 2) * 8 + half * 4 + (jj & 3); } return 512 + (n - 416); }
    case MAP_UQ: { const int head = n / 96, d = n % 96; if (d < 64) return head * 64 + d; const int dd = d - 64, half = dd >> 4, jj = dd & 15; return 384 + head * 32 + (jj >> 2) * 8 + half * 4 + (jj & 3); }
    case MAP_UKV: { const int head = n / 192, d = n % 192; if (d < 64) return head * 64 + d; return 512 + head * 128 + (d - 64); }
    default: return n;
    }
}
__device__ __forceinline__ void transpose_item(const float* W, int K, int N, bf16* WT, int mapk, const float* gain, LAS float* scr, int item, int lane) {
    const int nblk = (N + 63) / 64, kb = item / nblk, nb = item % nblk, k0 = 64 * kb, n0 = 64 * nb;
    const int kq = lane >> 4, nc = lane & 15; const bool nok = (n0 + 4 * nc) < N;
#pragma unroll 8
    for (int i = 0; i < 16; ++i) { const int kk = 4 * i + kq;
        f32x4 v = nok ? *(const f32x4*)(W + (size_t)(k0 + kk) * N + n0 + 4 * nc) : (f32x4){0.f, 0.f, 0.f, 0.f};
        LAS float* s = scr + kk * 65 + 4 * nc; s[0] = v[0]; s[1] = v[1]; s[2] = v[2]; s[3] = v[3]; }
    asm volatile("s_waitcnt lgkmcnt(0)" ::: "memory");
    const int c = lane & 7;
    float gv[8];
#pragma unroll
    for (int e = 0; e < 8; ++e) gv[e] = gain ? gain[k0 + 8 * c + e] : 1.0f;
#pragma unroll
    for (int j = 0; j < 8; ++j) { const int n = (lane >> 3) + 8 * j; const LAS float* s = scr + (8 * c) * 65 + n;
        v4u o; o.x = pk2(s[0 * 65] * gv[0], s[1 * 65] * gv[1]); o.y = pk2(s[2 * 65] * gv[2], s[3 * 65] * gv[3]); o.z = pk2(s[4 * 65] * gv[4], s[5 * 65] * gv[5]); o.w = pk2(s[6 * 65] * gv[6], s[7 * 65] * gv[7]);
        if (n0 + n < N) *(v4u*)(WT + (size_t)map_row(mapk, n0 + n) * K + k0 + 8 * c) = o; }
    asm volatile("s_waitcnt lgkmcnt(0)" ::: "memory");
}
__device__ __forceinline__ void norm_row_bf16(const float* xrow, const f32x4 (&g)[4], bf16* orow, float* xcopy, int lane) {
    f32x4 v[4]; float s = 0.f;
#pragma unroll
    for (int j = 0; j < 4; ++j) { v[j] = *(const f32x4*)(xrow + 4 * lane + 256 * j); s += (v[j][0] * v[j][0] + v[j][1] * v[j][1]) + (v[j][2] * v[j][2] + v[j][3] * v[j][3]); }
    const float rs = 1.0f / sqrtf(wave_sum(s) * (1.0f / DM) + EPS);
#pragma unroll
    for (int j = 0; j < 4; ++j) { if (xcopy) *(f32x4*)(xcopy + 4 * lane + 256 * j) = v[j];
        const f32x4 y = v[j] * rs * g[j]; v2u w; w.x = pk2(y[0], y[1]); w.y = pk2(y[2], y[3]); *(v2u*)(orow + 4 * lane + 256 * j) = w; }
}
__device__ __forceinline__ void row_phase(const float* D, float* X, bf16* XB, const float* gpost, float w, const float* gpre, int gw, int ngw, int lane) {
    f32x4 ga[4], gb[4];
#pragma unroll
    for (int j = 0; j < 4; ++j) { ga[j] = *(const f32x4*)(gpost + 4 * lane + 256 * j) * w; gb[j] = gpre ? *(const f32x4*)(gpre + 4 * lane + 256 * j) : (f32x4){0.f, 0.f, 0.f, 0.f}; }
    for (int row = gw; row < M; row += ngw) {
        const float* dr = D + (size_t)row * DM; float* xr = X + (size_t)row * DM;
        f32x4 d[4], x[4]; float s = 0.f;
#pragma unroll
        for (int j = 0; j < 4; ++j) { d[j] = *(const f32x4*)(dr + 4 * lane + 256 * j); x[j] = *(const f32x4*)(xr + 4 * lane + 256 * j); s += (d[j][0] * d[j][0] + d[j][1] * d[j][1]) + (d[j][2] * d[j][2] + d[j][3] * d[j][3]); }
        const float rs = 1.0f / sqrtf(wave_sum(s) * (1.0f / DM) + EPS); float s2 = 0.f;
#pragma unroll
        for (int j = 0; j < 4; ++j) { x[j] = x[j] + d[j] * rs * ga[j]; *(f32x4*)(xr + 4 * lane + 256 * j) = x[j]; s2 += (x[j][0] * x[j][0] + x[j][1] * x[j][1]) + (x[j][2] * x[j][2] + x[j][3] * x[j][3]); }
        if (gpre) { const float rs2 = 1.0f / sqrtf(wave_sum(s2) * (1.0f / DM) + EPS);
#pragma unroll
            for (int j = 0; j < 4; ++j) { const f32x4 y = x[j] * rs2 * gb[j]; v2u o; o.x = pk2(y[0], y[1]); o.y = pk2(y[2], y[3]); *(v2u*)(XB + (size_t)row * DM + 4 * lane + 256 * j) = o; } }
    }
}
__device__ __forceinline__ void sincos_rev(float ang, float& c, float& s) {
    const float C1 = 0.15915494309189535f, C2 = 6.42063833e-09f; const float hi = ang * C1; const float lo = fmaf(ang, C1, -hi) + ang * C2;
    float r = hi - floorf(hi); r += lo;
    s = __builtin_amdgcn_sinf(r); c = __builtin_amdgcn_cosf(r);
}

struct KArgs { const float* in[17]; float* out; unsigned char* ws; int lo, hi; };

enum { OP_PRO = 0, OP_MEMKV, OP_GU, OP_DN, OP_ROW, OP_RETIN, OP_MLAIN, OP_UQ, OP_UKV, OP_ATT, OP_WO };
constexpr int NSTEPS = 2 + 2 * 22;

__global__ void __launch_bounds__(NWAVES * 64, 2) fwd_mega(KArgs args) {
    extern __shared__ __attribute__((aligned(16))) unsigned char lds[];
    cg::grid_group grid = cg::this_grid();
    LAS unsigned char* ldsl = (LAS unsigned char*)lds;
    const int G = gridDim.x, bx = blockIdx.x; const int vcu = (G % 8 == 0) ? (bx % 8) * (G / 8) + bx / 8 : bx;
    const int NGW = G * NWAVES;
    const int hi_s = args.hi < NSTEPS ? args.hi : NSTEPS;

    for (int step = args.lo; step < hi_s; ++step) {
        int tid_ = threadIdx.x; asm volatile("" : "+v"(tid_));
        const int tid = tid_, lane = tid & 63, wave = __builtin_amdgcn_readfirstlane(tid >> 6), gw = bx * NWAVES + wave;
        size_t zoff = 0; asm volatile("" : "+s"(zoff));
        unsigned char* const ws = args.ws + zoff;
        const float* ngains = args.in[3]; float* X = args.out;
        bf16* const XB = (bf16*)(ws + WS_XB); float* const DBUF = (float*)(ws + WS_DBUF); bf16* const MIX = (bf16*)(ws + WS_MIX); bf16* const QM = (bf16*)(ws + WS_QM);
        unsigned char* const BIG = ws + WS_BIG;
        int op, l = 0, f = 0; bool sync_after = true;
        if (step == 0) op = OP_PRO; else if (step == 1) op = OP_MEMKV;
        else { const int s = step - 2, pair = s / 22, rem = s % 22;
            if (rem < 10) { l = 2 * pair; const int t = rem;
                op = t == 0 ? OP_GU : t == 1 ? OP_DN : t == 2 ? OP_ROW : t == 3 ? OP_RETIN : t == 4 ? OP_ATT : t == 5 ? OP_WO : t == 6 ? OP_ROW : t == 7 ? OP_GU : t == 8 ? OP_DN : OP_ROW;
                f = t <= 2 ? 0 : (t == 6 ? 1 : 2); }
            else { l = 2 * pair + 1; const int t = rem - 10;
                op = t == 0 ? OP_GU : t == 1 ? OP_DN : t == 2 ? OP_ROW : t == 3 ? OP_MLAIN : t == 4 ? OP_UQ : t == 5 ? OP_UKV : t == 6 ? OP_ATT : t == 7 ? OP_WO : t == 8 ? OP_ROW : t == 9 ? OP_GU : t == 10 ? OP_DN : OP_ROW;
                f = t <= 2 ? 0 : (t == 8 ? 1 : 2); if (t == 4) sync_after = false; } }
        const int r = l >> 1; const float* ng = ngains + (size_t)l * 6 * DM;

        if (op == OP_PRO) {
            const float* x_in = args.in[0]; const float* mem = args.in[1]; const int* pos = (const int*)args.in[2];
            bf16* WGU = (bf16*)(ws + WS_WGU); bf16* WDN = (bf16*)(ws + WS_WDN); bf16* WO = (bf16*)(ws + WS_WO); bf16* WRIN = (bf16*)(ws + WS_WRIN); bf16* WMIN = (bf16*)(ws + WS_WMIN);
            bf16* WUQ = (bf16*)(ws + WS_WUQ); bf16* WUKV = (bf16*)(ws + WS_WUKV); bf16* WMKV = (bf16*)(ws + WS_WMKV); bf16* MEMN = (bf16*)(ws + WS_MEMN);
            float* RCOS = (float*)(ws + WS_RCOS); float* RSIN = (float*)(ws + WS_RSIN); float* MCOS = (float*)(ws + WS_MCOS); float* MSIN = (float*)(ws + WS_MSIN);
            LAS float* scr = (LAS float*)(ldsl + wave * 16896);
            int base = 0;
            for (int wi = 0; wi < 8; ++wi) {
                const float* SRC; int KK, NN, NMAT, MAPK, GSTRIDE = 0; bf16* DST; size_t DSTSTRIDE; const float* GAIN = nullptr;
                switch (wi) {
                case 0: SRC = args.in[4]; KK = DM; NN = 2 * DFF; DST = WGU; DSTSTRIDE = (size_t)2 * DFF * DM; NMAT = 8; MAPK = MAP_GU; break;
                case 1: SRC = args.in[5]; KK = DFF; NN = DM; DST = WDN; DSTSTRIDE = (size_t)DM * DFF; NMAT = 8; MAPK = MAP_ID; break;
                case 2: SRC = args.in[6]; KK = DM; NN = DM; DST = WO; DSTSTRIDE = (size_t)DM * DM; NMAT = 4; MAPK = MAP_ID; break;
                case 3: SRC = args.in[9]; KK = DM; NN = RET_IN; DST = WRIN; DSTSTRIDE = (size_t)RET_IN * DM; NMAT = 2; MAPK = MAP_RETIN; break;
                case 4: SRC = args.in[12]; KK = DM; NN = MLA_IN; DST = WMIN; DSTSTRIDE = (size_t)MLA_INP * DM; NMAT = 2; MAPK = MAP_MLAIN; break;
                case 5: SRC = args.in[15]; KK = 256; NN = UQ_N; DST = WUQ; DSTSTRIDE = (size_t)UQ_NP * 256; NMAT = 2; MAPK = MAP_UQ; GAIN = args.in[13]; GSTRIDE = 256; break;
                case 6: SRC = args.in[16]; KK = 128; NN = UKV_N; DST = WUKV; DSTSTRIDE = (size_t)UKV_NP * 128; NMAT = 2; MAPK = MAP_UKV; GAIN = args.in[14]; GSTRIDE = 128; break;
                default: SRC = args.in[8]; KK = DM; NN = 512; DST = WMKV; DSTSTRIDE = (size_t)512 * DM; NMAT = 4; MAPK = MAP_ID; break;
                }
                const int per = (KK / 64) * ((NN + 63) / 64), tot = per * NMAT;
                for (int it = gw - base; it < tot; it += NGW) { if (it < 0) continue; const int mt = it / per, rr = it % per;
                    transpose_item(SRC + (size_t)mt * KK * NN, KK, NN, DST + (size_t)mt * DSTSTRIDE, MAPK, GAIN ? GAIN + mt * GSTRIDE : nullptr, scr, rr, lane); }
                base = (base + tot) % NGW;
            }
            const int gt = bx * (NWAVES * 64) + tid, NGT = G * NWAVES * 64;
            for (int i = gt; i < M * 64; i += NGT) { const int row = i >> 6, j = i & 63; const float inv = exp2f(-(float)j * (13.287712379549449f / 64.0f)); const float ang = (float)pos[row] * inv; float c, s; sincos_rev(ang, c, s); RCOS[i] = c; RSIN[i] = s; }
            for (int i = gt; i < M * 16; i += NGT) { const int row = i >> 4, j = i & 15; const float inv = exp2f(-(float)j * (13.287712379549449f / 16.0f)); const float ang = (float)pos[row] * inv; float c, s; sincos_rev(ang, c, s); MCOS[i] = c; MSIN[i] = s; }
            { f32x4 g[4];
#pragma unroll
              for (int j = 0; j < 4; ++j) g[j] = *(const f32x4*)(args.in[7] + 4 * lane + 256 * j);
              for (int rr = gw; rr < BATCH * MEML; rr += NGW) norm_row_bf16(mem + (size_t)rr * DM, g, MEMN + (size_t)rr * DM, nullptr, lane);
#pragma unroll
              for (int j = 0; j < 4; ++j) g[j] = *(const f32x4*)(ngains + 4 * lane + 256 * j);
              for (int rr = gw; rr < M; rr += NGW) norm_row_bf16(x_in + (size_t)rr * DM, g, XB + (size_t)rr * DM, X + (size_t)rr * DM, lane); }
        } else if (op == OP_ROW) {
            const float* gpost = ng + (f == 0 ? 1 : f == 1 ? 3 : 5) * DM; const float w = f == 1 ? 1.0f : 0.5f;
            const float* gpre = f == 0 ? ng + 2 * DM : f == 1 ? ng + 4 * DM : (l + 1 < DEPTH ? ngains + (size_t)(l + 1) * 6 * DM : nullptr);
            row_phase(DBUF, X, XB, gpost, w, gpre, gw, NGW, lane);
        } else if (op == OP_ATT) {
            const float* ret_ld = args.in[10]; const float* ret_hn = args.in[11]; const bf16* MEMKV = (const bf16*)(ws + WS_MEMKV);
            for (int u = vcu; u < 640; u += G) {
                att::Args a{};
                if (u < 384) { const int bh = u >> 3, qb = u & 7, b = bh / 6, h = bh % 6; const size_t rowq = (size_t)b * SEQ + qb * 256, rowk = (size_t)b * SEQ;
                    a.O = MIX + rowq * DM + h * 128; a.seq = SEQ;
                    if ((l & 1) == 0) {
                        const bf16* RQ = (const bf16*)(BIG + BIG_Q); const bf16* RK = (const bf16*)(BIG + BIG_K); const bf16* RV = (const bf16*)(BIG + BIG_V); const bf16* RG = (const bf16*)(BIG + BIG_G);
                        a.Q = RQ + rowq * 768 + h * 128; a.K1 = RK + rowk * 768 + h * 128; a.K2 = a.K1; a.V = RV + rowk * 768 + h * 128;
                        a.G = RG + rowq * 768 + h * 128; a.hn = ret_hn + (size_t)r * 768 + h * 128; a.qpos0 = qb * 256;
                        a.lf = ret_ld[(r * 2 + 0) * 6 + h] * 1.4426950408889634f; a.lb = ret_ld[(r * 2 + 1) * 6 + h] * 1.4426950408889634f;
#ifndef NO_ATT1
                        att::unit<1, 8, 4, 128, 768, 768, 768, 768>(a, (char*)lds);
#endif
                    } else {
                        const bf16* KR = (const bf16*)(BIG + BIG_KR); const bf16* QF = (const bf16*)(BIG + BIG_QF); const bf16* KN = (const bf16*)(BIG + BIG_KN); const bf16* VV = (const bf16*)(BIG + BIG_VV);
                        a.Q = QF + rowq * 576 + h * 96; a.K1 = KN + rowk * 384 + h * 64; a.K2 = KR + rowk * 32; a.V = VV + rowk * 768 + h * 128;
                        const float scale = 0.10206207261596577f; a.C = scale * 1.4426950408889634f; a.thr = 8.0f / scale;
#ifndef NO_ATT2
                        att::unit<0, 6, 4, 64, 576, 384, 32, 768>(a, (char*)lds);
#endif
                    }
                } else { const int mu = u - 384, bh = mu >> 3, qb = mu & 7, b = bh >> 2, h = bh & 3; const size_t rowq = (size_t)b * SEQ + qb * 256, rowk = (size_t)b * MEML;
                    a.Q = QM + rowq * 256 + h * 64; a.K1 = MEMKV + rowk * 2048 + l * 512 + h * 64; a.K2 = a.K1; a.V = MEMKV + rowk * 2048 + l * 512 + 256 + h * 64;
                    a.O = MIX + rowq * DM + 768 + h * 64; a.seq = MEML; a.C = 0.125f * 1.4426950408889634f; a.thr = 64.0f;
#ifndef NO_ATT3
                    att::unit<0, 4, 2, 64, 256, 2048, 2048, 2048>(a, (char*)lds);
#endif
                }
                __syncthreads();
            }
        } else {
            pg8::Epi E{}; E.ws = ws; const bf16* A; const bf16* Bt; int Mm = M, N, K;
            switch (op) {
            case OP_MEMKV: A = (const bf16*)(ws + WS_MEMN); Bt = (const bf16*)(ws + WS_WMKV); Mm = BATCH * MEML; N = 2048; K = DM; E.kind = pg8::EK_BF16; break;
            case OP_GU: A = XB; Bt = (const bf16*)(ws + WS_WGU) + (size_t)(l * 2 + (f == 2 ? 1 : 0)) * 2 * DFF * DM; N = 2 * DFF; K = DM; E.kind = pg8::EK_SWIGLU; break;
            case OP_DN: A = (const bf16*)BIG; Bt = (const bf16*)(ws + WS_WDN) + (size_t)(l * 2 + (f == 2 ? 1 : 0)) * DM * DFF; N = DM; K = DFF; E.kind = pg8::EK_F32; break;
            case OP_WO: A = MIX; Bt = (const bf16*)(ws + WS_WO) + (size_t)l * DM * DM; N = DM; K = DM; E.kind = pg8::EK_F32; break;
            case OP_RETIN: A = XB; Bt = (const bf16*)(ws + WS_WRIN) + (size_t)r * RET_IN * DM; N = RET_IN; K = DM; E.kind = pg8::EK_RETIN; break;
            case OP_MLAIN: A = XB; Bt = (const bf16*)(ws + WS_WMIN) + (size_t)r * MLA_INP * DM; N = MLA_INP; K = DM; E.kind = pg8::EK_MLAIN; break;
            case OP_UQ: A = (const bf16*)(BIG + BIG_CQ); Bt = (const bf16*)(ws + WS_WUQ) + (size_t)r * UQ_NP * 256; N = UQ_NP; K = 256; E.kind = pg8::EK_UQ; break;
            default: A = (const bf16*)(BIG + BIG_CKV); Bt = (const bf16*)(ws + WS_WUKV) + (size_t)r * UKV_NP * 128; N = UKV_NP; K = 128; E.kind = pg8::EK_UKV; break;
            }
            pg8::Gemm g{A, Bt, Mm, N, K}; pg8::StaticOrder S; S.init(Mm, N, G, bx);
#ifndef NO_GEMM
            pg8::gemm_phase<pg8::Epi, pg8::StaticOrder, true, true>(ldsl, g, S, E);
#endif
        }
        if (sync_after && step + 1 < hi_s) grid.sync();
    }
}

#ifndef MK_MULTI
#define MK_MULTI 1
#endif
extern "C" void kernel_launch(void* const* d_in, const int* in_sizes, int n_in, void* d_out, int out_size, void* d_ws, size_t ws_size, hipStream_t stream) {
    static int grid = 0;
    if (grid == 0) {
        if (n_in != 17 || out_size != M * DM || ws_size < WS_END) { fprintf(stderr, "kernel_launch: unexpected shapes (n_in %d out %d ws %zu)\n", n_in, out_size, ws_size); grid = -1; return; }
        int dev = 0, cus = 0, per_cu = 0;
        (void)hipGetDevice(&dev); (void)hipDeviceGetAttribute(&cus, hipDeviceAttributeMultiprocessorCount, dev);
        if (hipFuncSetAttribute((const void*)fwd_mega, hipFuncAttributeMaxDynamicSharedMemorySize, LDS_BYTES) != hipSuccess) { fprintf(stderr, "kernel_launch: hipFuncSetAttribute failed\n"); grid = -1; return; }
        if (hipOccupancyMaxActiveBlocksPerMultiprocessor(&per_cu, (const void*)fwd_mega, NWAVES * 64, LDS_BYTES) != hipSuccess || per_cu < 1) { fprintf(stderr, "kernel_launch: occupancy query gave %d\n", per_cu); per_cu = 1; }
        (void)hipGetLastError();
        grid = cus * per_cu;
        if (grid % 8 != 0 || grid > 1024 || grid < 8) grid = 256;
    }
    if (grid < 0) return;
    KArgs a{};
    for (int i = 0; i < 17; ++i) a.in[i] = (const float*)d_in[i];
    a.out = (float*)d_out; a.ws = (unsigned char*)d_ws;
#if MK_MULTI
    for (int s = 0; s < NSTEPS; ++s) { a.lo = s; a.hi = s + 1; hipLaunchKernelGGL(fwd_mega, dim3(grid), dim3(NWAVES * 64), LDS_BYTES, stream, a); }
#else
    a.lo = 0; a.hi = NSTEPS;
    void* kargs[] = {&a};
    hipError_t e = hipLaunchCooperativeKernel((const void*)fwd_mega, dim3(grid), dim3(NWAVES * 64), kargs, LDS_BYTES, stream);
    if (e != hipSuccess) fprintf(stderr, "cooperative launch failed: %s (grid %d)\n", hipGetErrorString(e), grid);
#endif
}
```
